# Optimizing an MI355X kernel written in HIP

```python
import math
import jax, jax.numpy as jnp
from jax import lax
import numpy as np

D_MODEL = 1024
BATCH = 2
SEQ = 8192
DEPTH = 1

CHUNK = 64
Q_BLOCK = 128
N_MEM = 256
EPS = 1e-6
ROPE_THETA = 500000.0

SB_HEADS = 8
SB_HEAD_DIM = D_MODEL // 16
SB_WIDTH = SB_HEADS * SB_HEAD_DIM
DF_HEADS = 4
DF_QK_DIM = D_MODEL // 32
DF_V_DIM = 2 * DF_QK_DIM
DF_WIDTH = DF_HEADS * DF_V_DIM
DF_ROT_DIMS = DF_QK_DIM // 4
MEM_HEADS = 4
MEM_HEAD_DIM = D_MODEL // 16
MEM_WIDTH = MEM_HEADS * MEM_HEAD_DIM
MIX_WIDTH = SB_WIDTH + DF_WIDTH + MEM_WIDTH

PROJ_SIZES = (SB_WIDTH, SB_WIDTH, SB_WIDTH, SB_WIDTH,
              2 * DF_HEADS * DF_QK_DIM, 2 * DF_HEADS * DF_QK_DIM,
              DF_WIDTH, DF_WIDTH,
              MEM_WIDTH, MEM_WIDTH)
PROJ_WIDTH = sum(PROJ_SIZES)

kernel_name = 'hymba_stickbreak_diffattn_memxattn_block'


def _rmsnorm(x, g):
    xf = x.astype(jnp.float32)
    y = xf * lax.rsqrt(jnp.mean(xf * xf, axis=-1, keepdims=True) + EPS)
    return (y * g.astype(jnp.float32)).astype(x.dtype)


def _split_proj(p):
    parts, off = [], 0
    for n in PROJ_SIZES:
        parts.append(p[..., off:off + n])
        off += n
    return parts


def _partial_rope(x, cos, sin):
    half = DF_ROT_DIMS // 2
    x1 = x[..., :half]
    x2 = x[..., half:DF_ROT_DIMS]
    r1 = (x1 * cos - x2 * sin).astype(x.dtype)
    r2 = (x2 * cos + x1 * sin).astype(x.dtype)
    return jnp.concatenate([r1, r2, x[..., DF_ROT_DIMS:]], axis=-1)


def _to_blocks(a):
    b, s = a.shape[:2]
    a = a.reshape((b, s // Q_BLOCK, Q_BLOCK) + a.shape[2:])
    return jnp.moveaxis(a, 1, 0)


def _from_blocks(a):
    a = jnp.moveaxis(a, 0, 1)
    return a.reshape((a.shape[0], a.shape[1] * a.shape[2]) + a.shape[3:])


def _stick_breaking(q, k, v):
    s_len = q.shape[1]
    scale = SB_HEAD_DIM ** -0.5
    key_idx = jnp.arange(s_len)

    def block(args):
        qb, t0 = args
        z = jnp.einsum('bqhd,bkhd->bhqk', qb, k).astype(jnp.float32) * scale
        q_idx = t0 + jnp.arange(Q_BLOCK)
        strict = key_idx[None, :] < q_idx[:, None]
        log_1mb = jnp.where(strict, jax.nn.log_sigmoid(-z), 0.0)
        between = lax.cumsum(log_1mb, axis=3, reverse=True) - log_1mb
        w = jnp.where(strict, jnp.exp(jax.nn.log_sigmoid(z) + between), 0.0)
        return jnp.einsum('bhqk,bkhd->bqhd', w.astype(v.dtype), v)

    starts = jnp.arange(s_len // Q_BLOCK, dtype=jnp.int32) * Q_BLOCK
    return _from_blocks(lax.map(block, (_to_blocks(q), starts)))


def _diff_attention(q, k, v, lam, lambda_init, g_subln):
    s_len = q.shape[1]
    scale = DF_QK_DIM ** -0.5
    key_chunk = jnp.arange(s_len) // CHUNK

    def block(args):
        qb, t0 = args
        sc = jnp.einsum('bqhmd,bkhmd->bhmqk', qb, k).astype(jnp.float32) * scale
        q_chunk = (t0 + jnp.arange(Q_BLOCK)) // CHUNK
        allowed = key_chunk[None, :] <= q_chunk[:, None]
        p = jax.nn.softmax(jnp.where(allowed, sc, -jnp.inf), axis=-1)
        a = p[:, :, 0] - lam * p[:, :, 1]
        return jnp.einsum('bhqk,bkhe->bqhe', a.astype(v.dtype), v)

    starts = jnp.arange(s_len // Q_BLOCK, dtype=jnp.int32) * Q_BLOCK
    o = _from_blocks(lax.map(block, (_to_blocks(q), starts)))
    return _rmsnorm(o, g_subln) * (1.0 - lambda_init)


def setup_inputs(seed: int = 0) -> dict:
    key = jax.random.key(seed)
    ks = jax.random.split(key, 12)
    f32 = jnp.float32
    x = jax.random.normal(ks[0], (BATCH, SEQ, D_MODEL), f32)
    mem = jax.random.normal(ks[1], (BATCH, N_MEM, D_MODEL), f32)
    offset = jax.random.randint(ks[2], (BATCH, 1), 0, 4096, dtype=jnp.int32)
    positions = (offset + jnp.arange(SEQ, dtype=jnp.int32)[None, :]).astype(jnp.int32)
    w_in = jax.random.normal(ks[3], (DEPTH, D_MODEL, PROJ_WIDTH), f32) * D_MODEL ** -0.5
    w_mem_kv = jax.random.normal(ks[4], (DEPTH, D_MODEL, 2 * MEM_WIDTH), f32) * D_MODEL ** -0.5
    w_out = jax.random.normal(ks[5], (DEPTH, MIX_WIDTH, D_MODEL), f32) * MIX_WIDTH ** -0.5
    g_pre = 1.0 + 0.02 * jax.random.normal(ks[6], (DEPTH, D_MODEL), f32)
    g_post = 1.0 + 0.02 * jax.random.normal(ks[7], (DEPTH, D_MODEL), f32)
    g_mem = 1.0 + 0.02 * jax.random.normal(ks[8], (DEPTH, D_MODEL), f32)
    g_subln = 1.0 + 0.02 * jax.random.normal(ks[9], (DEPTH, DF_V_DIM), f32)
    df_lambda = 0.1 * jax.random.normal(ks[10], (DEPTH, 4, DF_QK_DIM), f32)
    return {'x': x, 'mem': mem, 'positions': positions, 'w_in': w_in, 'w_mem_kv': w_mem_kv,
            'w_out': w_out, 'g_pre': g_pre, 'g_post': g_post, 'g_mem': g_mem,
            'g_subln': g_subln, 'df_lambda': df_lambda}


def reference(x, mem, positions, w_in, w_mem_kv, w_out, g_pre, g_post, g_mem, g_subln, df_lambda):
    b, s_len, _ = x.shape
    n_mem = mem.shape[1]
    inv_freq = 1.0 / (ROPE_THETA ** (jnp.arange(0, DF_ROT_DIMS, 2, dtype=jnp.float32) / DF_ROT_DIMS))
    ang = positions.astype(jnp.float32)[:, :, None] * inv_freq
    cos = jnp.cos(ang)[:, :, None, None, :]
    sin = jnp.sin(ang)[:, :, None, None, :]

    for layer in range(DEPTH):
        lambda_init = 0.8 - 0.6 * math.exp(-0.3 * layer)
        h = _rmsnorm(x, g_pre[layer])
        proj = h @ w_in[layer]
        sb_q, sb_k, sb_v, sb_g, df_q, df_k, df_v, df_g, m_q, m_g = _split_proj(proj)

        shp = (b, s_len, SB_HEADS, SB_HEAD_DIM)
        y_sb = _stick_breaking(sb_q.reshape(shp), sb_k.reshape(shp), sb_v.reshape(shp))
        y_sb = y_sb.reshape(b, s_len, SB_WIDTH) * jax.nn.silu(sb_g)

        qk_shp = (b, s_len, DF_HEADS, 2, DF_QK_DIM)
        dq = _partial_rope(df_q.reshape(qk_shp), cos, sin)
        dk = _partial_rope(df_k.reshape(qk_shp), cos, sin)
        lp = df_lambda[layer].astype(jnp.float32)
        lam = jnp.exp(jnp.sum(lp[0] * lp[1])) - jnp.exp(jnp.sum(lp[2] * lp[3])) + lambda_init
        y_df = _diff_attention(dq, dk, df_v.reshape(b, s_len, DF_HEADS, DF_V_DIM),
                               lam, lambda_init, g_subln[layer])
        y_df = y_df.reshape(b, s_len, DF_WIDTH) * jax.nn.silu(df_g)

        mkv = (_rmsnorm(mem, g_mem[layer]) @ w_mem_kv[layer]).reshape(b, n_mem, 2, MEM_HEADS, MEM_HEAD_DIM)
        mq = m_q.reshape(b, s_len, MEM_HEADS, MEM_HEAD_DIM)
        sc = jnp.einsum('bshd,bmhd->bhsm', mq, mkv[:, :, 0]).astype(jnp.float32) * MEM_HEAD_DIM ** -0.5
        pm = jax.nn.softmax(sc, axis=-1).astype(mkv.dtype)
        y_m = jnp.einsum('bhsm,bmhd->bshd', pm, mkv[:, :, 1]).reshape(b, s_len, MEM_WIDTH) * jax.nn.silu(m_g)

        y = jnp.concatenate([y_sb, y_df, y_m], axis=-1) @ w_out[layer]
        x = x + _rmsnorm(y, g_post[layer])
    return x
```

```cpp
#include <hip/hip_runtime.h>
#include <stdint.h>

constexpr int D_MODEL = 1024, BATCH = 2, SEQ = 8192, MTOK = BATCH * SEQ, NMEM = 256;
constexpr int PROJ_W = 3584;
constexpr int C_SBQ = 0, C_SBK = 512, C_SBV = 1024, C_SBG = 1536, C_DFQ = 2048, C_DFK = 2304, C_DFV = 2560, C_DFG = 2816, C_MQ = 3072, C_MG = 3328;
constexpr float EPS = 1e-6f;
constexpr float LOG2E = 1.4426950408889634f;
constexpr float SB_QSCALE = 0.125f * LOG2E;
constexpr float DF_QSCALE = 0.17677669529663687f * LOG2E;
constexpr float M_QSCALE = 0.125f * LOG2E;
constexpr float LAMBDA_INIT = 0.2f;
constexpr float SB_EXIT = 150.0f;

constexpr size_t MiB = 1u << 20;
constexpr size_t WS_CTL = 0;
constexpr size_t WS_WIN = 2 * MiB;
constexpr size_t WS_WOUT = 10 * MiB;
constexpr size_t WS_WMEM = 12 * MiB;
constexpr size_t WS_MEMN = 13 * MiB;
constexpr size_t WS_ROPE = 14 * MiB;
constexpr size_t WS_MKV = 15 * MiB;
constexpr size_t WS_XN = 16 * MiB;
constexpr size_t WS_PROJ = 48 * MiB;
constexpr size_t WS_Y = 160 * MiB;
constexpr size_t WS_YO = 192 * MiB;
constexpr int CW_KINF = 64;

typedef unsigned short bf16_t;
typedef short bf16x8 __attribute__((ext_vector_type(8)));
typedef float f32x16 __attribute__((ext_vector_type(16)));
typedef float f32x4 __attribute__((ext_vector_type(4)));

__device__ __forceinline__ float bf2f(bf16_t v) { return __uint_as_float(((unsigned)v) << 16); }
__device__ __forceinline__ bf16_t f2bf(float f) { unsigned u = __float_as_uint(f); return (bf16_t)((u + 0x7fffu + ((u >> 16) & 1u)) >> 16); }
__device__ __forceinline__ float wave_sum(float v) {
#pragma unroll
    for (int o = 1; o < 64; o <<= 1) v += __shfl_xor(v, o);
    return v;
}
__device__ __forceinline__ float silu(float g) { return g / (1.0f + __expf(-g)); }

__global__ void __launch_bounds__(256) prep_x(const float* __restrict__ x, const int* __restrict__ pos, bf16_t* __restrict__ xn, float* __restrict__ rope) {
    const int lane = threadIdx.x & 63, row = blockIdx.x * 4 + (threadIdx.x >> 6);
    const f32x4* xr = (const f32x4*)(x + (size_t)row * D_MODEL) + lane;
    f32x4 v[4]; float s = 0.f;
#pragma unroll
    for (int j = 0; j < 4; ++j) { v[j] = xr[64 * j]; s += (v[j].x * v[j].x + v[j].y * v[j].y) + (v[j].z * v[j].z + v[j].w * v[j].w); }
    const float rstd = rsqrtf(wave_sum(s) * (1.0f / D_MODEL) + EPS);
    uint2* o = (uint2*)(xn + (size_t)row * D_MODEL) + lane;
#pragma unroll
    for (int j = 0; j < 4; ++j) { uint2 w; w.x = f2bf(v[j].x * rstd) | ((unsigned)f2bf(v[j].y * rstd) << 16); w.y = f2bf(v[j].z * rstd) | ((unsigned)f2bf(v[j].w * rstd) << 16); o[64 * j] = w; }
    if (lane < 4) {
        const float inv_freq = 1.0f / powf(500000.0f, (float)lane * 0.25f);
        const float ang = (float)pos[row] * inv_freq;
        float sn, cs; sincosf(ang, &sn, &cs);
        rope[(size_t)row * 8 + lane] = cs; rope[(size_t)row * 8 + 4 + lane] = sn;
    }
}
__global__ void __launch_bounds__(256) prep_mem(const float* __restrict__ mem, const float* __restrict__ g, bf16_t* __restrict__ memn) {
    const int lane = threadIdx.x & 63, row = blockIdx.x * 4 + (threadIdx.x >> 6);
    const f32x4* xr = (const f32x4*)(mem + (size_t)row * D_MODEL) + lane; const f32x4* gr = (const f32x4*)g + lane;
    f32x4 v[4]; float s = 0.f;
#pragma unroll
    for (int j = 0; j < 4; ++j) { v[j] = xr[64 * j]; s += (v[j].x * v[j].x + v[j].y * v[j].y) + (v[j].z * v[j].z + v[j].w * v[j].w); }
    const float rstd = rsqrtf(wave_sum(s) * (1.0f / D_MODEL) + EPS);
    uint2* o = (uint2*)(memn + (size_t)row * D_MODEL) + lane;
#pragma unroll
    for (int j = 0; j < 4; ++j) { const f32x4 gg = gr[64 * j]; uint2 w; w.x = f2bf(v[j].x * rstd * gg.x) | ((unsigned)f2bf(v[j].y * rstd * gg.y) << 16); w.y = f2bf(v[j].z * rstd * gg.z) | ((unsigned)f2bf(v[j].w * rstd * gg.w) << 16); o[64 * j] = w; }
}
__global__ void __launch_bounds__(256) prep_wt(const float* __restrict__ W, const float* __restrict__ gk, bf16_t* __restrict__ WT, int K, int N) {
    __shared__ float t[32][33];
    const int tx = threadIdx.x & 31, ty = threadIdx.x >> 5, k0 = blockIdx.y * 32, n0 = blockIdx.x * 32;
#pragma unroll
    for (int i = 0; i < 4; ++i) { const int k = k0 + ty + 8 * i; t[ty + 8 * i][tx] = W[(size_t)k * N + n0 + tx] * (gk ? gk[k] : 1.0f); }
    __syncthreads();
#pragma unroll
    for (int i = 0; i < 4; ++i) { const int n = n0 + ty + 8 * i; WT[(size_t)n * K + k0 + tx] = f2bf(t[tx][ty + 8 * i]); }
}

struct EpiProj { bf16_t* P; __device__ __forceinline__ void operator()(int row, int col, float v) const {
    if (col < C_SBK) v *= SB_QSCALE; else if (col >= C_DFQ && col < C_DFK) v *= DF_QSCALE; else if (col >= C_MQ && col < C_MG) v *= M_QSCALE;
    P[(size_t)row * PROJ_W + col] = f2bf(v); } };
struct EpiBf { bf16_t* P; int ld; __device__ __forceinline__ void operator()(int row, int col, float v) const { P[(size_t)row * ld + col] = f2bf(v); } };
struct EpiF32 { float* P; int ld; __device__ __forceinline__ void operator()(int row, int col, float v) const { P[(size_t)row * ld + col] = v; } };

template <class Epi>
__global__ void __launch_bounds__(256) gemm_simple(const bf16_t* __restrict__ A, const bf16_t* __restrict__ Bt, int K, Epi epi) {
    const int lane = threadIdx.x & 63, wid = threadIdx.x >> 6, r = lane & 31, h = lane >> 5;
    const int row0 = blockIdx.y * 128 + (wid >> 1) * 64, col0 = blockIdx.x * 128 + (wid & 1) * 64;
    f32x16 acc[2][2];
#pragma unroll
    for (int i = 0; i < 2; ++i)
#pragma unroll
        for (int j = 0; j < 2; ++j)
#pragma unroll
            for (int e = 0; e < 16; ++e) acc[i][j][e] = 0.f;
    const bf16_t* ap = A + (size_t)(row0 + r) * K + 8 * h;
    const bf16_t* bp = Bt + (size_t)(col0 + r) * K + 8 * h;
    for (int k0 = 0; k0 < K; k0 += 16) {
        bf16x8 a[2], b[2];
#pragma unroll
        for (int i = 0; i < 2; ++i) { a[i] = *(const bf16x8*)(ap + (size_t)(32 * i) * K + k0); b[i] = *(const bf16x8*)(bp + (size_t)(32 * i) * K + k0); }
#pragma unroll
        for (int i = 0; i < 2; ++i)
#pragma unroll
            for (int j = 0; j < 2; ++j) acc[i][j] = __builtin_amdgcn_mfma_f32_32x32x16_bf16(a[i], b[j], acc[i][j], 0, 0, 0);
    }
#pragma unroll
    for (int i = 0; i < 2; ++i)
#pragma unroll
        for (int j = 0; j < 2; ++j)
#pragma unroll
            for (int e = 0; e < 16; ++e) epi(row0 + 32 * i + (e & 3) + 8 * (e >> 2) + 4 * h, col0 + 32 * j + r, acc[i][j][e]);
}

__global__ void __launch_bounds__(256) rope_kernel(bf16_t* __restrict__ P, const float* __restrict__ rope) {
    const int idx = blockIdx.x * 256 + threadIdx.x;
    const int i = idx & 3, g = (idx >> 2) & 15, row = idx >> 6;
    bf16_t* p = P + (size_t)row * PROJ_W + C_DFQ + g * 32;
    const float cs = rope[(size_t)row * 8 + i], sn = rope[(size_t)row * 8 + 4 + i];
    const float x1 = bf2f(p[i]), x2 = bf2f(p[i + 4]);
    p[i] = f2bf(x1 * cs - x2 * sn); p[i + 4] = f2bf(x2 * cs + x1 * sn);
}
__global__ void __launch_bounds__(256) kinf_kernel(const bf16_t* __restrict__ P, unsigned* __restrict__ kinf) {
    const int row0 = blockIdx.x * 64, b = row0 / SEQ;
    float mx[2] = {0.f, 0.f};
    for (int rr = 0; rr < 64; ++rr) { const unsigned w = *(const unsigned*)(P + (size_t)(row0 + rr) * PROJ_W + C_SBK + threadIdx.x * 2);
        mx[0] = fmaxf(mx[0], fabsf(bf2f((bf16_t)(w & 0xffff)))); mx[1] = fmaxf(mx[1], fabsf(bf2f((bf16_t)(w >> 16)))); }
    float m = fmaxf(mx[0], mx[1]);
#pragma unroll
    for (int o = 1; o < 32; o <<= 1) m = fmaxf(m, __shfl_xor(m, o));
    if ((threadIdx.x & 31) == 0) atomicMax(kinf + b * 8 + (threadIdx.x >> 5), __float_as_uint(m));
}

__device__ __forceinline__ void load64(const bf16_t* p, float* f) {
#pragma unroll
    for (int c = 0; c < 8; ++c) { const uint4 w = *(const uint4*)(p + 8 * c);
        f[8 * c + 0] = __uint_as_float(w.x << 16); f[8 * c + 1] = __uint_as_float(w.x & 0xffff0000u); f[8 * c + 2] = __uint_as_float(w.y << 16); f[8 * c + 3] = __uint_as_float(w.y & 0xffff0000u);
        f[8 * c + 4] = __uint_as_float(w.z << 16); f[8 * c + 5] = __uint_as_float(w.z & 0xffff0000u); f[8 * c + 6] = __uint_as_float(w.w << 16); f[8 * c + 7] = __uint_as_float(w.w & 0xffff0000u); }
}
__device__ __forceinline__ void load32(const bf16_t* p, float* f) {
#pragma unroll
    for (int c = 0; c < 4; ++c) { const uint4 w = *(const uint4*)(p + 8 * c);
        f[8 * c + 0] = __uint_as_float(w.x << 16); f[8 * c + 1] = __uint_as_float(w.x & 0xffff0000u); f[8 * c + 2] = __uint_as_float(w.y << 16); f[8 * c + 3] = __uint_as_float(w.y & 0xffff0000u);
        f[8 * c + 4] = __uint_as_float(w.z << 16); f[8 * c + 5] = __uint_as_float(w.z & 0xffff0000u); f[8 * c + 6] = __uint_as_float(w.w << 16); f[8 * c + 7] = __uint_as_float(w.w & 0xffff0000u); }
}
__global__ void __launch_bounds__(256) sb_naive(const bf16_t* __restrict__ P, const unsigned* __restrict__ kinf, bf16_t* __restrict__ Y) {
    const int t = blockIdx.x * 256 + threadIdx.x, bh = blockIdx.y, b = bh >> 3, h = bh & 7;
    const size_t row = (size_t)b * SEQ + t;
    float q[64], o[64];
    load64(P + row * PROJ_W + C_SBQ + h * 64, q);
    float q1 = 0.f;
#pragma unroll
    for (int d = 0; d < 64; ++d) { o[d] = 0.f; q1 += fabsf(q[d]); }
    const float bound = q1 * __uint_as_float(kinf[bh]) * 1.01f + SB_EXIT;
    float R = 0.f;
    for (int j = t - 1; j >= 0; --j) {
        const bf16_t* kp = P + ((size_t)b * SEQ + j) * PROJ_W + C_SBK + h * 64;
        float z = 0.f;
#pragma unroll
        for (int c = 0; c < 8; ++c) { const uint4 w = *(const uint4*)(kp + 8 * c);
            z += q[8 * c + 0] * __uint_as_float(w.x << 16) + q[8 * c + 1] * __uint_as_float(w.x & 0xffff0000u) + q[8 * c + 2] * __uint_as_float(w.y << 16) + q[8 * c + 3] * __uint_as_float(w.y & 0xffff0000u)
               + q[8 * c + 4] * __uint_as_float(w.z << 16) + q[8 * c + 5] * __uint_as_float(w.z & 0xffff0000u) + q[8 * c + 6] * __uint_as_float(w.w << 16) + q[8 * c + 7] * __uint_as_float(w.w & 0xffff0000u); }
        const float sp = fminf(__builtin_amdgcn_logf(1.0f + __builtin_amdgcn_exp2f(z)), 60000.f);
        R += sp;
        const float w = __builtin_amdgcn_exp2f(fminf(z - R, 0.f));
        const bf16_t* vp = kp + (C_SBV - C_SBK);
#pragma unroll
        for (int c = 0; c < 8; ++c) { const uint4 u = *(const uint4*)(vp + 8 * c);
            o[8 * c + 0] += w * __uint_as_float(u.x << 16); o[8 * c + 1] += w * __uint_as_float(u.x & 0xffff0000u); o[8 * c + 2] += w * __uint_as_float(u.y << 16); o[8 * c + 3] += w * __uint_as_float(u.y & 0xffff0000u);
            o[8 * c + 4] += w * __uint_as_float(u.z << 16); o[8 * c + 5] += w * __uint_as_float(u.z & 0xffff0000u); o[8 * c + 6] += w * __uint_as_float(u.w << 16); o[8 * c + 7] += w * __uint_as_float(u.w & 0xffff0000u); }
        if (R > bound) break;
    }
    float g[64]; load64(P + row * PROJ_W + C_SBG + h * 64, g);
    bf16_t* yp = Y + row * D_MODEL + h * 64;
#pragma unroll
    for (int d = 0; d < 64; d += 2) *(unsigned*)(yp + d) = f2bf(o[d] * silu(g[d])) | ((unsigned)f2bf(o[d + 1] * silu(g[d + 1])) << 16);
}
__global__ void __launch_bounds__(256) df_naive(const bf16_t* __restrict__ P, float* __restrict__ T) {
    const int t = blockIdx.x * 256 + threadIdx.x, m = blockIdx.y & 1, h = (blockIdx.y >> 1) & 3, b = blockIdx.y >> 3;
    const size_t row = (size_t)b * SEQ + t;
    float q[32], o[64];
    load32(P + row * PROJ_W + C_DFQ + h * 64 + m * 32, q);
#pragma unroll
    for (int d = 0; d < 64; ++d) o[d] = 0.f;
    float mx = -INFINITY, l = 0.f;
    const int nk = (t / 64 + 1) * 64;
    for (int j = 0; j < nk; ++j) {
        const bf16_t* kp = P + ((size_t)b * SEQ + j) * PROJ_W + C_DFK + h * 64 + m * 32;
        float s = 0.f;
#pragma unroll
        for (int c = 0; c < 4; ++c) { const uint4 w = *(const uint4*)(kp + 8 * c);
            s += q[8 * c + 0] * __uint_as_float(w.x << 16) + q[8 * c + 1] * __uint_as_float(w.x & 0xffff0000u) + q[8 * c + 2] * __uint_as_float(w.y << 16) + q[8 * c + 3] * __uint_as_float(w.y & 0xffff0000u)
               + q[8 * c + 4] * __uint_as_float(w.z << 16) + q[8 * c + 5] * __uint_as_float(w.z & 0xffff0000u) + q[8 * c + 6] * __uint_as_float(w.w << 16) + q[8 * c + 7] * __uint_as_float(w.w & 0xffff0000u); }
        if (s > mx) { const float al = __builtin_amdgcn_exp2f(mx - s); l *= al;
#pragma unroll
            for (int d = 0; d < 64; ++d) o[d] *= al;
            mx = s; }
        const float p = __builtin_amdgcn_exp2f(s - mx); l += p;
        const bf16_t* vp = P + ((size_t)b * SEQ + j) * PROJ_W + C_DFV + h * 64;
#pragma unroll
        for (int c = 0; c < 8; ++c) { const uint4 u = *(const uint4*)(vp + 8 * c);
            o[8 * c + 0] += p * __uint_as_float(u.x << 16); o[8 * c + 1] += p * __uint_as_float(u.x & 0xffff0000u); o[8 * c + 2] += p * __uint_as_float(u.y << 16); o[8 * c + 3] += p * __uint_as_float(u.y & 0xffff0000u);
            o[8 * c + 4] += p * __uint_as_float(u.z << 16); o[8 * c + 5] += p * __uint_as_float(u.z & 0xffff0000u); o[8 * c + 6] += p * __uint_as_float(u.w << 16); o[8 * c + 7] += p * __uint_as_float(u.w & 0xffff0000u); }
    }
    const float il = 1.0f / l;
    float* tp = T + ((row * 4 + h) * 2 + m) * 64;
#pragma unroll
    for (int d = 0; d < 64; d += 4) *(f32x4*)(tp + d) = (f32x4){o[d] * il, o[d + 1] * il, o[d + 2] * il, o[d + 3] * il};
}
__global__ void __launch_bounds__(256) df_combine(const float* __restrict__ T, const bf16_t* __restrict__ P, const float* __restrict__ lamp, const float* __restrict__ gsub, bf16_t* __restrict__ Y) {
    const int idx = blockIdx.x * 256 + threadIdx.x, h = idx & 3; const size_t row = idx >> 2;
    float s01 = 0.f, s23 = 0.f;
    for (int d = 0; d < 32; ++d) { s01 += lamp[d] * lamp[32 + d]; s23 += lamp[64 + d] * lamp[96 + d]; }
    const float lam = expf(s01) - expf(s23) + LAMBDA_INIT;
    const float* tp = T + (row * 4 + h) * 128;
    float o[64]; float ss = 0.f;
#pragma unroll
    for (int d = 0; d < 64; ++d) { o[d] = tp[d] - lam * tp[64 + d]; ss += o[d] * o[d]; }
    const float rstd = rsqrtf(ss * (1.0f / 64.0f) + EPS) * (1.0f - LAMBDA_INIT);
    float g[64]; load64(P + row * PROJ_W + C_DFG + h * 64, g);
    bf16_t* yp = Y + row * D_MODEL + 512 + h * 64;
#pragma unroll
    for (int d = 0; d < 64; d += 2) *(unsigned*)(yp + d) = f2bf(o[d] * rstd * gsub[d] * silu(g[d])) | ((unsigned)f2bf(o[d + 1] * rstd * gsub[d + 1] * silu(g[d + 1])) << 16);
}
__global__ void __launch_bounds__(256) mem_naive(const bf16_t* __restrict__ P, const bf16_t* __restrict__ MKV, bf16_t* __restrict__ Y) {
    const int t = blockIdx.x * 256 + threadIdx.x, h = blockIdx.y & 3, b = blockIdx.y >> 2;
    const size_t row = (size_t)b * SEQ + t;
    float q[64], o[64];
    load64(P + row * PROJ_W + C_MQ + h * 64, q);
#pragma unroll
    for (int d = 0; d < 64; ++d) o[d] = 0.f;
    float mx = -INFINITY, l = 0.f;
    for (int j = 0; j < NMEM; ++j) {
        const bf16_t* kp = MKV + (size_t)(b * NMEM + j) * 512 + h * 64;
        float s = 0.f;
#pragma unroll
        for (int c = 0; c < 8; ++c) { const uint4 w = *(const uint4*)(kp + 8 * c);
            s += q[8 * c + 0] * __uint_as_float(w.x << 16) + q[8 * c + 1] * __uint_as_float(w.x & 0xffff0000u) + q[8 * c + 2] * __uint_as_float(w.y << 16) + q[8 * c + 3] * __uint_as_float(w.y & 0xffff0000u)
               + q[8 * c + 4] * __uint_as_float(w.z << 16) + q[8 * c + 5] * __uint_as_float(w.z & 0xffff0000u) + q[8 * c + 6] * __uint_as_float(w.w << 16) + q[8 * c + 7] * __uint_as_float(w.w & 0xffff0000u); }
        if (s > mx) { const float al = __builtin_amdgcn_exp2f(mx - s); l *= al;
#pragma unroll
            for (int d = 0; d < 64; ++d) o[d] *= al;
            mx = s; }
        const float p = __builtin_amdgcn_exp2f(s - mx); l += p;
        const bf16_t* vp = kp + 256;
#pragma unroll
        for (int c = 0; c < 8; ++c) { const uint4 u = *(const uint4*)(vp + 8 * c);
            o[8 * c + 0] += p * __uint_as_float(u.x << 16); o[8 * c + 1] += p * __uint_as_float(u.x & 0xffff0000u); o[8 * c + 2] += p * __uint_as_float(u.y << 16); o[8 * c + 3] += p * __uint_as_float(u.y & 0xffff0000u);
            o[8 * c + 4] += p * __uint_as_float(u.z << 16); o[8 * c + 5] += p * __uint_as_float(u.z & 0xffff0000u); o[8 * c + 6] += p * __uint_as_float(u.w << 16); o[8 * c + 7] += p * __uint_as_float(u.w & 0xffff0000u); }
    }
    const float il = 1.0f / l;
    float g[64]; load64(P + row * PROJ_W + C_MG + h * 64, g);
    bf16_t* yp = Y + row * D_MODEL + 768 + h * 64;
#pragma unroll
    for (int d = 0; d < 64; d += 2) *(unsigned*)(yp + d) = f2bf(o[d] * il * silu(g[d])) | ((unsigned)f2bf(o[d + 1] * il * silu(g[d + 1])) << 16);
}
__global__ void __launch_bounds__(256) post_norm(const float* __restrict__ x, const float* __restrict__ yo, const float* __restrict__ g, float* __restrict__ out) {
    const int lane = threadIdx.x & 63; const size_t row = blockIdx.x * 4 + (threadIdx.x >> 6);
    const f32x4* yr = (const f32x4*)(yo + row * D_MODEL) + lane; const f32x4* xr = (const f32x4*)(x + row * D_MODEL) + lane; const f32x4* gr = (const f32x4*)g + lane;
    f32x4 v[4]; float s = 0.f;
#pragma unroll
    for (int j = 0; j < 4; ++j) { v[j] = yr[64 * j]; s += (v[j].x * v[j].x + v[j].y * v[j].y) + (v[j].z * v[j].z + v[j].w * v[j].w); }
    const float rstd = rsqrtf(wave_sum(s) * (1.0f / D_MODEL) + EPS);
    f32x4* o = (f32x4*)(out + row * D_MODEL) + lane;
#pragma unroll
    for (int j = 0; j < 4; ++j) o[64 * j] = xr[64 * j] + v[j] * rstd * gr[64 * j];
}

extern "C" void kernel_launch(void* const* d_in, const int* in_sizes, int n_in, void* d_out, int out_size, void* d_ws, size_t ws_size, hipStream_t stream) {
    const float* x = (const float*)d_in[0]; const float* mem = (const float*)d_in[1]; const int* pos = (const int*)d_in[2];
    const float* w_in = (const float*)d_in[3]; const float* w_mem = (const float*)d_in[4]; const float* w_out = (const float*)d_in[5];
    const float* g_pre = (const float*)d_in[6]; const float* g_post = (const float*)d_in[7]; const float* g_mem = (const float*)d_in[8];
    const float* g_sub = (const float*)d_in[9]; const float* lamp = (const float*)d_in[10];
    unsigned char* ws = (unsigned char*)d_ws;
    unsigned* ctl = (unsigned*)(ws + WS_CTL);
    bf16_t* WIN = (bf16_t*)(ws + WS_WIN); bf16_t* WOUT = (bf16_t*)(ws + WS_WOUT); bf16_t* WMEM = (bf16_t*)(ws + WS_WMEM); bf16_t* MEMN = (bf16_t*)(ws + WS_MEMN);
    float* ROPE = (float*)(ws + WS_ROPE); bf16_t* MKV = (bf16_t*)(ws + WS_MKV); bf16_t* XN = (bf16_t*)(ws + WS_XN); bf16_t* PROJ = (bf16_t*)(ws + WS_PROJ);
    bf16_t* Y = (bf16_t*)(ws + WS_Y); float* YO = (float*)(ws + WS_YO);
    hipMemsetAsync(ws + WS_CTL, 0, MiB, stream);
    prep_x<<<MTOK / 4, 256, 0, stream>>>(x, pos, XN, ROPE);
    prep_mem<<<BATCH * NMEM / 4, 256, 0, stream>>>(mem, g_mem, MEMN);
    prep_wt<<<dim3(PROJ_W / 32, D_MODEL / 32), 256, 0, stream>>>(w_in, g_pre, WIN, D_MODEL, PROJ_W);
    prep_wt<<<dim3(D_MODEL / 32, D_MODEL / 32), 256, 0, stream>>>(w_out, nullptr, WOUT, D_MODEL, D_MODEL);
    prep_wt<<<dim3(512 / 32, D_MODEL / 32), 256, 0, stream>>>(w_mem, nullptr, WMEM, D_MODEL, 512);
    gemm_simple<EpiProj><<<dim3(PROJ_W / 128, MTOK / 128), 256, 0, stream>>>(XN, WIN, D_MODEL, EpiProj{PROJ});
    gemm_simple<EpiBf><<<dim3(512 / 128, BATCH * NMEM / 128), 256, 0, stream>>>(MEMN, WMEM, D_MODEL, EpiBf{MKV, 512});
    rope_kernel<<<MTOK * 64 / 256, 256, 0, stream>>>(PROJ, ROPE);
    kinf_kernel<<<MTOK / 64, 256, 0, stream>>>(PROJ, ctl + CW_KINF);
    sb_naive<<<dim3(SEQ / 256, 16), 256, 0, stream>>>(PROJ, ctl + CW_KINF, Y);
    df_naive<<<dim3(SEQ / 256, 16), 256, 0, stream>>>(PROJ, YO);
    df_combine<<<MTOK * 4 / 256, 256, 0, stream>>>(YO, PROJ, lamp, g_sub, Y);
    mem_naive<<<dim3(SEQ / 256, 8), 256, 0, stream>>>(PROJ, MKV, Y);
    gemm_simple<EpiF32><<<dim3(D_MODEL / 128, MTOK / 128), 256, 0, stream>>>(Y, WOUT, D_MODEL, EpiF32{YO, D_MODEL});
    post_norm<<<MTOK / 4, 256, 0, stream>>>(x, YO, g_post, (float*)d_out);
}
```
